# Optimizing an MI355X kernel written in HIP

```python
import jax, jax.numpy as jnp
from jax import lax
import numpy as np

D_MODEL = 1024
BATCH = 8
SEQ = 2048
DEPTH = 4
DEC_BATCH = 128
DEC_SEQ = 8
PAST_LEN = 16384
PAGE_SIZE = 128

N_META = 16
N_HEADS = 8
HEAD_K = 128
HEAD_V = D_MODEL // N_HEADS
KEY_DIM = N_HEADS * HEAD_K
CHUNK = 16
CONV_W = 3
D_FF = -(-8 * D_MODEL // (3 * 256)) * 256
N_HGRN = (DEPTH + 1) // 2
N_CONV = DEPTH // 2
EPS = 1e-6

kernel_name = "hgrn2_shortconv_hybrid_step"


def rmsnorm(x, g):
    xf = x.astype(jnp.float32)
    y = xf * lax.rsqrt(jnp.mean(xf * xf, axis=-1, keepdims=True) + EPS)
    return (y * g.astype(jnp.float32)).astype(x.dtype)


def swiglu(h, w_gate, w_up, w_down):
    return (jax.nn.silu(h @ w_gate) * (h @ w_up)) @ w_down


def layer_lower_bounds(lb_logits):
    sm = jax.nn.softmax(lb_logits.astype(jnp.float32), axis=0)
    return jnp.cumsum(sm, axis=0) - sm[0:1]


def _chunk_major(a, n):
    b, t, h, e = a.shape
    return a.reshape(b, n, CHUNK, h, e).transpose(1, 0, 3, 2, 4)


def gla_chunked(q, k, v, log_f, s0):
    bsz, t = q.shape[:2]
    pad = (-t) % CHUNK
    pw = ((0, 0), (0, pad), (0, 0), (0, 0))
    q, k, v, log_f = [jnp.pad(a, pw) for a in (q, k, v, log_f)]
    n = (t + pad) // CHUNK
    xs = tuple(_chunk_major(a, n) for a in (q, k, v, log_f))
    causal = jnp.tril(jnp.ones((CHUNK, CHUNK), dtype=bool))[:, :, None]

    def step(S, inp):
        qc, kc, vc, gc = inp
        b = jnp.cumsum(gc, axis=2)
        diff = b[:, :, :, None, :] - b[:, :, None, :, :]
        decay = jnp.where(causal, jnp.exp(jnp.where(causal, diff, 0.0)), 0.0)
        scores = jnp.einsum('bhid,bhjd,bhijd->bhij', qc, kc, decay)
        o = (jnp.einsum('bhij,bhje->bhie', scores, vc)
             + jnp.einsum('bhid,bhde->bhie', qc * jnp.exp(b), S))
        b_last = b[:, :, -1:, :]
        S = (jnp.exp(b_last[:, :, 0, :, None]) * S
             + jnp.einsum('bhjd,bhje->bhde', kc * jnp.exp(b_last - b), vc))
        return S, o

    S, o = lax.scan(step, s0, xs)
    o = o.transpose(1, 0, 3, 2, 4).reshape(bsz, n * CHUNK, N_HEADS, -1)[:, :t]
    return o, S


def hgrn2_mixer(h, s0, w_in, w_out, lb, g_norm):
    bsz, t, _ = h.shape
    proj = h @ w_in
    q = proj[..., :KEY_DIM]
    z = proj[..., KEY_DIM:2 * KEY_DIM]
    i = proj[..., 2 * KEY_DIM:2 * KEY_DIM + D_MODEL]
    g = proj[..., 2 * KEY_DIM + D_MODEL:]
    q = jax.nn.silu(q.astype(jnp.float32)).reshape(bsz, t, N_HEADS, HEAD_K)
    z = z.astype(jnp.float32).reshape(bsz, t, N_HEADS, HEAD_K)
    lbh = lb.reshape(N_HEADS, HEAD_K)
    log_f = jnp.log(lbh + (1.0 - lbh) * jax.nn.sigmoid(z))
    k = (1.0 - lbh) * jax.nn.sigmoid(-z)
    v = i.astype(jnp.float32).reshape(bsz, t, N_HEADS, HEAD_V)
    o, s = gla_chunked(q, k, v, log_f, s0.astype(jnp.float32))
    o = rmsnorm(o.reshape(bsz, t, D_MODEL), g_norm) * jax.nn.silu(g.astype(jnp.float32))
    return o.astype(h.dtype) @ w_out, s


def shortconv_mixer(h, buf, w_in, w_conv, w_out):
    t = h.shape[1]
    proj = h @ w_in
    gate_b = proj[..., :D_MODEL]
    gate_c = proj[..., D_MODEL:2 * D_MODEL]
    u = gate_c * proj[..., 2 * D_MODEL:]
    full = jnp.concatenate([buf.astype(u.dtype), u], axis=1)
    y = sum(w_conv[tap] * full[:, tap:tap + t] for tap in range(CONV_W))
    return (gate_b * y) @ w_out, full[:, -(CONV_W - 1):]


def trunk(x, s_hgrn, s_conv, lb, norm_mix, norm_ffn, norm_final, hgrn_w_in, hgrn_w_out,
          hgrn_norm, conv_w_in, conv_w, conv_w_out, ffn_w_gate, ffn_w_up, ffn_w_down):
    new_h, new_c = [], []
    for l in range(DEPTH):
        h = rmsnorm(x, norm_mix[l])
        j = l // 2
        if l % 2 == 0:
            m, s = hgrn2_mixer(h, s_hgrn[j], hgrn_w_in[j], hgrn_w_out[j], lb[j], hgrn_norm[j])
            new_h.append(s)
        else:
            m, s = shortconv_mixer(h, s_conv[j], conv_w_in[j], conv_w[j], conv_w_out[j])
            new_c.append(s)
        x = x + m.astype(x.dtype)
        x = x + swiglu(rmsnorm(x, norm_ffn[l]), ffn_w_gate[l], ffn_w_up[l], ffn_w_down[l]).astype(x.dtype)
    return rmsnorm(x, norm_final), jnp.stack(new_h), jnp.stack(new_c)


def setup_inputs(seed: int = 0) -> dict:
    key = jax.random.key(seed)
    ks = jax.random.split(key, 20)

    def nrm(k, shape, scale):
        return jax.random.normal(k, shape, jnp.float32) * scale

    return {
        "x_prompt": nrm(ks[0], (BATCH, SEQ, D_MODEL), 1.0),
        "x_sample": nrm(ks[1], (DEC_BATCH, DEC_SEQ, D_MODEL), 1.0),
        "state_hgrn": nrm(ks[2], (N_HGRN, DEC_BATCH, N_HEADS, HEAD_K, HEAD_V), 0.5),
        "state_conv": nrm(ks[3], (N_CONV, DEC_BATCH, CONV_W - 1, D_MODEL), 1.0),
        "meta_tokens": nrm(ks[4], (N_META, D_MODEL), 1.0),
        "norm_mix": 1.0 + nrm(ks[5], (DEPTH, D_MODEL), 0.01),
        "norm_ffn": 1.0 + nrm(ks[6], (DEPTH, D_MODEL), 0.01),
        "norm_final": 1.0 + nrm(ks[7], (D_MODEL,), 0.01),
        "hgrn_w_in": nrm(ks[8], (N_HGRN, D_MODEL, 2 * KEY_DIM + 2 * D_MODEL), D_MODEL ** -0.5),
        "hgrn_w_out": nrm(ks[9], (N_HGRN, D_MODEL, D_MODEL), D_MODEL ** -0.5),
        "hgrn_lb_logits": nrm(ks[10], (N_HGRN, KEY_DIM), 0.5),
        "hgrn_norm": 1.0 + nrm(ks[11], (N_HGRN, D_MODEL), 0.01),
        "conv_w_in": nrm(ks[12], (N_CONV, D_MODEL, 3 * D_MODEL), D_MODEL ** -0.5),
        "conv_w": nrm(ks[13], (N_CONV, CONV_W, D_MODEL), CONV_W ** -0.5),
        "conv_w_out": nrm(ks[14], (N_CONV, D_MODEL, D_MODEL), D_MODEL ** -0.5),
        "ffn_w_gate": nrm(ks[15], (DEPTH, D_MODEL, D_FF), D_MODEL ** -0.5),
        "ffn_w_up": nrm(ks[16], (DEPTH, D_MODEL, D_FF), D_MODEL ** -0.5),
        "ffn_w_down": nrm(ks[17], (DEPTH, D_FF, D_MODEL), D_FF ** -0.5),
    }


def reference(x_prompt, x_sample, state_hgrn, state_conv, meta_tokens, norm_mix, norm_ffn,
              norm_final, hgrn_w_in, hgrn_w_out, hgrn_lb_logits, hgrn_norm, conv_w_in, conv_w,
              conv_w_out, ffn_w_gate, ffn_w_up, ffn_w_down):
    lb = layer_lower_bounds(hgrn_lb_logits)
    weights = (norm_mix, norm_ffn, norm_final, hgrn_w_in, hgrn_w_out, hgrn_norm,
               conv_w_in, conv_w, conv_w_out, ffn_w_gate, ffn_w_up, ffn_w_down)
    bsz = x_prompt.shape[0]
    meta = jnp.broadcast_to(meta_tokens.astype(x_prompt.dtype)[None], (bsz, N_META, D_MODEL))
    xp = jnp.concatenate([meta, x_prompt], axis=1)
    zeros_h = jnp.zeros((N_HGRN, bsz, N_HEADS, HEAD_K, HEAD_V), jnp.float32)
    zeros_c = jnp.zeros((N_CONV, bsz, CONV_W - 1, D_MODEL), x_prompt.dtype)
    yp, new_hgrn_prompt, new_conv_prompt = trunk(xp, zeros_h, zeros_c, lb, *weights)
    y_sample, new_hgrn_sample, new_conv_sample = trunk(x_sample, state_hgrn, state_conv, lb, *weights)
    return (yp[:, N_META:], y_sample, new_hgrn_prompt, new_conv_prompt, new_hgrn_sample, new_conv_sample)
```

```cpp
#include <hip/hip_runtime.h>
#include <hip/hip_cooperative_groups.h>
#include <cstdio>
#include <cstdint>
namespace pg8 {
#define PG8_LAS __attribute__((address_space(3)))
typedef unsigned short bf16_t;
typedef short bf16x8 __attribute__((ext_vector_type(8)));
typedef float f32x4 __attribute__((ext_vector_type(4)));
typedef unsigned u32x4 __attribute__((ext_vector_type(4)));
constexpr int BM = 256, BK = 64, HALF = 128, HTB = HALF * BK * 2  , STAGE_BYTES = 8 * HTB, NXCD = 8, WGM = 8;

__host__ __device__ __forceinline__ int lds_byte(int r, int c) { const int st = (r >> 4) * 2 + (c >> 5), rr = r & 15, cc = c & 31, ob = rr * 64 + cc * 2; return st * 1024 + (ob ^ (((ob >> 9) & 1) << 5)); }
__host__ __device__ __forceinline__ void stage_rc(int b, int& R, int& C) { const int st = b / 1024, sb = b % 1024, swz = sb ^ (((sb >> 9) & 1) << 5); R = (st >> 1) * 16 + swz / 64; C = (st & 1) * 32 + (swz % 64) / 2; }
__host__ __device__ __forceinline__ int perm32(int rho) { const int n = rho >> 4, i = rho & 15; return 8 * (i >> 2) + 4 * n + (i & 3); }

struct Unit { int pm, pn; };
struct Gemm { const bf16_t* A; const bf16_t* Bt; int M, N, K; };

struct StaticOrder {
    int nM, nN, nwg, G, c;
    __host__ __device__ void init(int M, int N, int G_, int c_) { nM = M / BM; nN = N / BM; nwg = nM * nN; G = G_; c = c_; }
    __host__ __device__ bool next(int i, Unit& u) const {
        const long L = (long)i * G + c; if (L >= nwg) return false;
        int wgid = (int)L; { const int q = nwg / NXCD, r = nwg % NXCD, xcd = wgid % NXCD, off = wgid / NXCD; wgid = (xcd < r ? xcd * (q + 1) : r * (q + 1) + (xcd - r) * q) + off; }
        const int nig = WGM * nN, gid = wgid / nig, fm = gid * WGM, gsz = (nM - fm) < WGM ? (nM - fm) : WGM;
        u.pm = fm + ((wgid % nig) % gsz); u.pn = (wgid % nig) / gsz; return true;
    }
    __device__ __forceinline__ void a_ready(const Unit&) const {}
    __device__ __forceinline__ void done(const Unit&) const {}
};

__device__ __forceinline__ unsigned cvt_pk_bf16(float lo, float hi) { unsigned r; asm volatile("v_cvt_pk_bf16_f32 %0, %1, %2" : "=v"(r) : "v"(lo), "v"(hi)); return r; }
typedef float f32x2 __attribute__((ext_vector_type(2)));

constexpr int DM = 1024, DFF = 2816, SROW_TILE = 65;
constexpr float RMS_EPS = 1e-6f;
typedef unsigned u32x2 __attribute__((ext_vector_type(2)));
__device__ __forceinline__ float frcp(float x) { return __builtin_amdgcn_rcpf(x); }
__device__ __forceinline__ float rstd_of(float ss) { return rsqrtf(ss * (1.0f / DM) + RMS_EPS); }
__device__ __forceinline__ float rstd16(const float* p) { const f32x4 a = *(const f32x4*)p, b = *(const f32x4*)(p + 4), c = *(const f32x4*)(p + 8), d = *(const f32x4*)(p + 12);
    return rstd_of((((a[0] + a[1]) + (a[2] + a[3])) + ((b[0] + b[1]) + (b[2] + b[3]))) + (((c[0] + c[1]) + (c[2] + c[3])) + ((d[0] + d[1]) + (d[2] + d[3])))); }
__device__ __forceinline__ float rstd8(const float* p) { const f32x4 a = *(const f32x4*)p, b = *(const f32x4*)(p + 4); return rstd_of(((a[0] + a[1]) + (a[2] + a[3])) + ((b[0] + b[1]) + (b[2] + b[3]))); }
__device__ __forceinline__ float silu_f(float x) { return x * frcp(1.0f + __expf(-x)); }
template <int S> __device__ __forceinline__ float row_shr(float v) {
    return __builtin_bit_cast(float, __builtin_amdgcn_update_dpp(0, __builtin_bit_cast(int, v), 0x110 + S, 0xf, 0xf, true));
}
__device__ __forceinline__ u32x4 pack8(const float (&v)[8]) { u32x4 w; w.x = cvt_pk_bf16(v[0], v[1]); w.y = cvt_pk_bf16(v[2], v[3]); w.z = cvt_pk_bf16(v[4], v[5]); w.w = cvt_pk_bf16(v[6], v[7]); return w; }

struct EpiRes {
    static constexpr bool PERM = false, AFTER_DRAIN = false;
    float* X; bf16_t* XB; const float* oss; float* ssn;
    __device__ __forceinline__ void operator()(const f32x4 (&acc)[2][2][4][2], const Unit& u, int wr, int wc, int fr, int fq) const {
        const int rowb = u.pm * BM + wr * 64 + fr, col0 = u.pn * BM + wc * 32 + 4 * fq;
#pragma unroll
        for (int ai = 0; ai < 2; ++ai)
#pragma unroll
            for (int m = 0; m < 4; ++m) {
                const int row = rowb + ai * HALF + m * 16; const float s = oss ? rstd8(oss + (size_t)row * 8) : 1.0f; float q = 0.f;
                const size_t off = (size_t)row * DM + col0;
#pragma unroll
                for (int bj = 0; bj < 2; ++bj)
#pragma unroll
                    for (int n = 0; n < 2; ++n) { const size_t o = off + bj * HALF + n * 16; const f32x4 xv = *(const f32x4*)(X + o); const f32x4 v = xv + acc[ai][bj][m][n] * s;
                        *(f32x4*)(X + o) = v; u32x2 w; w.x = cvt_pk_bf16(v[0], v[1]); w.y = cvt_pk_bf16(v[2], v[3]); *(u32x2*)(XB + o) = w;
                        q += (v[0] * v[0] + v[1] * v[1]) + (v[2] * v[2] + v[3] * v[3]); }
                q += __shfl_xor(q, 16); q += __shfl_xor(q, 32);
                if (fq == 0) ssn[(size_t)row * 16 + u.pn * 4 + wc] = q;
            }
    }
};
struct EpiGU {
    static constexpr bool PERM = true, AFTER_DRAIN = false;
    const float* ss; bf16_t* H;
    __device__ __forceinline__ void operator()(const f32x4 (&acc)[2][2][4][2], const Unit& u, int wr, int wc, int fr, int fq) const {
        const int rowb = u.pm * BM + wr * 64 + fr, col0 = u.pn * HALF + wc * 32 + 8 * fq;
#pragma unroll
        for (int ai = 0; ai < 2; ++ai)
#pragma unroll
            for (int m = 0; m < 4; ++m) {
                const int row = rowb + ai * HALF + m * 16; const float r = rstd16(ss + (size_t)row * 16); float hv[8];
#pragma unroll
                for (int n = 0; n < 2; ++n)
#pragma unroll
                    for (int i = 0; i < 4; ++i) { const float g = r * acc[ai][0][m][n][i], up = r * acc[ai][1][m][n][i]; hv[n * 4 + i] = silu_f(g) * up; }
                *(u32x4*)(H + (size_t)row * DFF + col0) = pack8(hv);
            }
    }
};
struct EpiConvIn {
    static constexpr bool PERM = true, AFTER_DRAIN = false;
    const float* ss; bf16_t* U; bf16_t* GB;
    __device__ __forceinline__ void operator()(const f32x4 (&acc)[2][2][4][2], const Unit& u, int wr, int wc, int fr, int fq) const {
        const int rowb = u.pm * BM + wr * 64 + fr;
#pragma unroll
        for (int ai = 0; ai < 2; ++ai)
#pragma unroll
            for (int m = 0; m < 4; ++m) {
                const int row = rowb + ai * HALF + m * 16; const float r = rstd16(ss + (size_t)row * 16);
                if (u.pn < 8) { float v[8]; const float r2 = r * r;
#pragma unroll
                    for (int n = 0; n < 2; ++n)
#pragma unroll
                        for (int i = 0; i < 4; ++i) v[n * 4 + i] = r2 * acc[ai][0][m][n][i] * acc[ai][1][m][n][i];
                    *(u32x4*)(U + (size_t)row * DM + u.pn * HALF + wc * 32 + 8 * fq) = pack8(v);
                } else {
#pragma unroll
                    for (int bj = 0; bj < 2; ++bj) { float v[8];
#pragma unroll
                        for (int n = 0; n < 2; ++n)
#pragma unroll
                            for (int i = 0; i < 4; ++i) v[n * 4 + i] = r * acc[ai][bj][m][n][i];
                        *(u32x4*)(GB + (size_t)row * DM + (u.pn - 8) * BM + bj * HALF + wc * 32 + 8 * fq) = pack8(v); }
                }
            }
    }
};
struct EpiHgrnIn {
    static constexpr bool PERM = true, AFTER_DRAIN = false;
    const float* ss; const float* lb0; const float* lb1; const float* gnorm;
    bf16_t *Qs, *Ks, *V, *Gp; float* ebl;
    __device__ __forceinline__ void operator()(const f32x4 (&acc)[2][2][4][2], const Unit& u, int wr, int wc, int fr, int fq) const {
        const int rowb = u.pm * BM + wr * 64 + fr;
        if (u.pn < 8) {
            const int c0 = u.pn * HALF + wc * 32 + 8 * fq;
            float lbv[8];
#pragma unroll
            for (int k = 0; k < 8; ++k) lbv[k] = lb1 ? frcp(1.0f + __expf(lb0[c0 + k] - lb1[c0 + k])) : 0.0f;
            const bool smp = u.pm >= SROW_TILE; const int pos = smp ? (fr & 7) : fr; const bool lastp = pos == (smp ? 7 : 15);
#pragma unroll
            for (int ai = 0; ai < 2; ++ai)
#pragma unroll
                for (int m = 0; m < 4; ++m) {
                    const int row = rowb + ai * HALF + m * 16; const float r = rstd16(ss + (size_t)row * 16);
                    float qs[8], ks[8], eb[8];
#pragma unroll
                    for (int n = 0; n < 2; ++n)
#pragma unroll
                        for (int i = 0; i < 4; ++i) { const int k = n * 4 + i;
                            const float qv = r * acc[ai][0][m][n][i], zv = r * acc[ai][1][m][n][i];
                            const float e = __expf(-zv), sg = frcp(1.0f + e);
                            float b = __logf((1.0f + lbv[k] * e) * sg);
                            const float kin = (1.0f - lbv[k]) * e * sg;
                            float t = row_shr<1>(b); b += (pos >= 1) ? t : 0.f;
                            t = row_shr<2>(b); b += (pos >= 2) ? t : 0.f;
                            t = row_shr<4>(b); b += (pos >= 4) ? t : 0.f;
                            if (!smp) { t = row_shr<8>(b); b += (pos >= 8) ? t : 0.f; }
                            const float ebv = __expf(b);
                            qs[k] = silu_f(qv) * ebv; ks[k] = kin * __expf(-b); eb[k] = ebv; }
                    *(u32x4*)(Qs + (size_t)row * DM + c0) = pack8(qs);
                    *(u32x4*)(Ks + (size_t)row * DM + c0) = pack8(ks);
                    if (lastp) { float* ep = ebl + (size_t)(row >> 3) * DM + c0; *(f32x4*)ep = (f32x4){eb[0], eb[1], eb[2], eb[3]}; *(f32x4*)(ep + 4) = (f32x4){eb[4], eb[5], eb[6], eb[7]}; }
                }
        } else {
            const bool isg = u.pn >= 12; bf16_t* dst = isg ? Gp : V; const int cb = (u.pn - (isg ? 12 : 8)) * BM + wc * 32 + 8 * fq;
#pragma unroll
            for (int bj = 0; bj < 2; ++bj) { float gn[8];
#pragma unroll
                for (int k = 0; k < 8; ++k) gn[k] = isg ? gnorm[cb + bj * HALF + k] : 1.0f;
#pragma unroll
                for (int ai = 0; ai < 2; ++ai)
#pragma unroll
                    for (int m = 0; m < 4; ++m) {
                        const int row = rowb + ai * HALF + m * 16; const float r = rstd16(ss + (size_t)row * 16); float v[8];
#pragma unroll
                        for (int n = 0; n < 2; ++n)
#pragma unroll
                            for (int i = 0; i < 4; ++i) { const float a = r * acc[ai][bj][m][n][i]; v[n * 4 + i] = isg ? silu_f(a) * gn[n * 4 + i] : a; }
                        *(u32x4*)(dst + (size_t)row * DM + cb + bj * HALF) = pack8(v);
                    }
            }
        }
    }
};
template <class Epi, class Sched, bool ALIGN_EPI = false, bool SP2 = false>
__device__ __forceinline__ void gemm_phase(PG8_LAS unsigned char* lds, const Gemm g, const Sched& S, const Epi& E) {
    int tid_ = threadIdx.x; asm volatile("" : "+v"(tid_));
    const int tid = tid_, wid = __builtin_amdgcn_readfirstlane(tid >> 6), lane = tid & 63, wr = wid >> 2, wc = wid & 3, fr = lane & 15, fq = lane >> 4;
    const int K = g.K, nt = K / BK;
    unsigned voffA[2], voffB[2];
#pragma unroll
    for (int i = 0; i < 2; ++i) { int R, C; stage_rc(tid * 16 + i * 8192, R, C); const int Rb = Epi::PERM ? ((R & ~31) + perm32(R & 31)) : R;
        voffA[i] = (unsigned)(R * K + C) * 2u; voffB[i] = (unsigned)(Rb * K + C) * 2u; }
    const size_t kstep = (size_t)(BK * 2);
    const size_t hstep = (size_t)HALF * K * 2;
    const size_t tstep = 2 * hstep;
    const unsigned ldsw = (unsigned)wid * 1024u;
    const int aoff = lds_byte(wr * 64 + fr, fq * 8), boff = lds_byte(wc * 32 + fr, fq * 8);
#define PG8_SA(b, h) (((b) * 2 + (h)) * HTB)
#define PG8_SB(b, h) ((4 + (b) * 2 + (h)) * HTB)
#define PG8_STAGE(bufoff, gbase, voff) do { _Pragma("unroll") for (int _i = 0; _i < 2; ++_i) \
        __builtin_amdgcn_global_load_lds((const unsigned*)((const char*)(gbase) + (voff)[_i]), (PG8_LAS unsigned*)(lds + (bufoff) + ldsw + _i * 8192), 16, 0, 0); } while (0)
#define PG8_LDA(dst, b, h) do { _Pragma("unroll") for (int m = 0; m < 4; ++m) _Pragma("unroll") for (int k = 0; k < 2; ++k) dst[m][k] = *(const PG8_LAS bf16x8*)(lds + PG8_SA(b, h) + aoff + m * 2048 + k * 1024); } while (0)
#define PG8_LDB(dst, b, h) do { _Pragma("unroll") for (int n = 0; n < 2; ++n) _Pragma("unroll") for (int k = 0; k < 2; ++k) dst[n][k] = *(const PG8_LAS bf16x8*)(lds + PG8_SB(b, h) + boff + n * 2048 + k * 1024); } while (0)
#define PG8_MMA(ai, bj, At, Bt) do { __builtin_amdgcn_s_setprio(1); _Pragma("unroll") for (int m = 0; m < 4; ++m) _Pragma("unroll") for (int n = 0; n < 2; ++n) _Pragma("unroll") for (int k = 0; k < 2; ++k) \
        acc[ai][bj][m][n] = __builtin_amdgcn_mfma_f32_16x16x32_bf16(Bt[n][k], At[m][k], acc[ai][bj][m][n], 0, 0, 0); __builtin_amdgcn_s_setprio(0); } while (0)
#define PG8_WAIT_V(n) asm volatile("s_waitcnt vmcnt(" #n ")" ::: "memory")
#define PG8_WAIT_L(n) asm volatile("s_waitcnt lgkmcnt(" #n ")" ::: "memory")
#define PG8_BAR __builtin_amdgcn_s_barrier()
#define PG8_SCHED __builtin_amdgcn_sched_barrier(0)
    Unit cur, nxt; int ui = 0;
    if (!S.next(0, cur)) return;
    f32x4 acc[2][2][4][2];
#pragma unroll
    for (int a = 0; a < 2; ++a)
#pragma unroll
        for (int b = 0; b < 2; ++b)
#pragma unroll
            for (int m = 0; m < 4; ++m)
#pragma unroll
                for (int n = 0; n < 2; ++n) acc[a][b][m][n] = (f32x4){0.f, 0.f, 0.f, 0.f};
    bf16x8 At[4][2], B0[2][2], B1[2][2];
    const char* cA = (const char*)g.A + (size_t)cur.pm * tstep; const char* cB = (const char*)g.Bt + (size_t)cur.pn * tstep;
    S.a_ready(cur);
    if constexpr (SP2) {
        PG8_STAGE(PG8_SB(0, 0), cB, voffB); PG8_STAGE(PG8_SB(0, 1), cB + hstep, voffB); PG8_STAGE(PG8_SA(0, 0), cA, voffA); PG8_STAGE(PG8_SA(0, 1), cA + hstep, voffA);
        if (wr == 1) PG8_BAR;
        PG8_WAIT_V(2); PG8_BAR;
        PG8_STAGE(PG8_SB(1, 0), cB + kstep, voffB); PG8_STAGE(PG8_SA(1, 0), cA + kstep, voffA); PG8_STAGE(PG8_SB(1, 1), cB + hstep + kstep, voffB);
        PG8_WAIT_V(6); PG8_BAR;
    } else {
        PG8_STAGE(PG8_SB(0, 0), cB, voffB); PG8_STAGE(PG8_SA(0, 0), cA, voffA); PG8_STAGE(PG8_SB(0, 1), cB + hstep, voffB); PG8_STAGE(PG8_SA(0, 1), cA + hstep, voffA);
        if (wr == 1) PG8_BAR;
        PG8_WAIT_V(4); PG8_BAR;
        PG8_STAGE(PG8_SB(1, 0), cB + kstep, voffB); PG8_STAGE(PG8_SA(1, 0), cA + kstep, voffA); PG8_STAGE(PG8_SB(1, 1), cB + hstep + kstep, voffB);
        PG8_WAIT_V(6); PG8_BAR;
    }
    for (;;) {
        const bool has_next = S.next(ui + 1, nxt);
        const char* nA = has_next ? (const char*)g.A + (size_t)nxt.pm * tstep : cA; const char* nB = has_next ? (const char*)g.Bt + (size_t)nxt.pn * tstep : cB;
        for (int t = 0; t < nt; t += 2) {
            const bool last = (t == nt - 2);
            const char* a1 = cA + (size_t)(t + 1) * kstep;
            const char* a2 = last ? nA : cA + (size_t)(t + 2) * kstep; const char* b2 = last ? nB : cB + (size_t)(t + 2) * kstep;
            const char* a3 = a2 + kstep; const char* b3 = b2 + kstep;
            if (last && has_next) S.a_ready(nxt);
            if constexpr (SP2) {
            PG8_LDB(B0, 0, 0); PG8_LDB(B1, 0, 1); PG8_SCHED; PG8_LDA(At, 0, 0); PG8_STAGE(PG8_SA(1, 1), a1 + hstep, voffA);
            PG8_WAIT_V(8); PG8_WAIT_L(0); PG8_BAR; PG8_MMA(0, 0, At, B0); PG8_MMA(0, 1, At, B1); PG8_BAR; PG8_SCHED;
            PG8_LDA(At, 0, 1); PG8_STAGE(PG8_SB(0, 0), b2, voffB); PG8_STAGE(PG8_SB(0, 1), b2 + hstep, voffB); PG8_STAGE(PG8_SA(0, 0), a2, voffA);
            PG8_WAIT_V(8); PG8_WAIT_L(0); PG8_BAR; PG8_MMA(1, 0, At, B0); PG8_MMA(1, 1, At, B1); PG8_BAR; PG8_SCHED;
            PG8_LDB(B0, 1, 0); PG8_LDB(B1, 1, 1); PG8_SCHED; PG8_LDA(At, 1, 0); PG8_STAGE(PG8_SA(0, 1), a2 + hstep, voffA);
            PG8_WAIT_V(8); PG8_WAIT_L(0); PG8_BAR; PG8_MMA(0, 0, At, B0); PG8_MMA(0, 1, At, B1); PG8_BAR; PG8_SCHED;
            PG8_LDA(At, 1, 1); PG8_STAGE(PG8_SB(1, 0), b3, voffB); PG8_STAGE(PG8_SB(1, 1), b3 + hstep, voffB); PG8_STAGE(PG8_SA(1, 0), a3, voffA);
            PG8_WAIT_V(8); PG8_WAIT_L(0); PG8_BAR; PG8_MMA(1, 0, At, B0); PG8_MMA(1, 1, At, B1); PG8_BAR; PG8_SCHED;
            } else {
            PG8_LDB(B0, 0, 0); PG8_SCHED; PG8_LDA(At, 0, 0); PG8_STAGE(PG8_SA(1, 1), a1 + hstep, voffA);
            PG8_WAIT_L(8); PG8_BAR; PG8_WAIT_L(0); PG8_MMA(0, 0, At, B0); PG8_BAR; PG8_SCHED;
            PG8_LDB(B1, 0, 1); PG8_STAGE(PG8_SB(0, 0), b2, voffB);
            PG8_BAR; PG8_WAIT_L(0); PG8_MMA(0, 1, At, B1); PG8_BAR;
            PG8_LDA(At, 0, 1); PG8_STAGE(PG8_SA(0, 0), a2, voffA);
            PG8_BAR; PG8_WAIT_L(0); PG8_MMA(1, 0, At, B0); PG8_BAR; PG8_SCHED;
            PG8_STAGE(PG8_SB(0, 1), b2 + hstep, voffB);
            PG8_WAIT_V(6); PG8_BAR; PG8_MMA(1, 1, At, B1); PG8_BAR;
            PG8_LDB(B0, 1, 0); PG8_SCHED; PG8_LDA(At, 1, 0); PG8_STAGE(PG8_SA(0, 1), a2 + hstep, voffA);
            PG8_WAIT_L(8); PG8_BAR; PG8_WAIT_L(0); PG8_MMA(0, 0, At, B0); PG8_BAR; PG8_SCHED;
            PG8_LDB(B1, 1, 1); PG8_STAGE(PG8_SB(1, 0), b3, voffB);
            PG8_BAR; PG8_WAIT_L(0); PG8_MMA(0, 1, At, B1); PG8_BAR;
            PG8_LDA(At, 1, 1); PG8_STAGE(PG8_SA(1, 0), a3, voffA);
            PG8_BAR; PG8_WAIT_L(0); PG8_MMA(1, 0, At, B0); PG8_BAR; PG8_SCHED;
            PG8_STAGE(PG8_SB(1, 1), b3 + hstep, voffB);
            PG8_WAIT_V(6); PG8_BAR; PG8_MMA(1, 1, At, B1); PG8_BAR;
            }
        }
        if constexpr (ALIGN_EPI) { if (wr == 0) PG8_BAR; }
        if constexpr (!Epi::AFTER_DRAIN) { E(acc, cur, wr, wc, fr, fq); S.done(cur); }
        if (!has_next) break;
#pragma unroll
        for (int a = 0; a < 2; ++a)
#pragma unroll
            for (int b = 0; b < 2; ++b)
#pragma unroll
                for (int m = 0; m < 4; ++m)
#pragma unroll
                    for (int n = 0; n < 2; ++n) acc[a][b][m][n] = (f32x4){0.f, 0.f, 0.f, 0.f};
        cur = nxt; cA = nA; cB = nB; ++ui;
        if constexpr (ALIGN_EPI) { if (wr == 1) PG8_BAR; }
    }
    PG8_WAIT_V(0);
    if constexpr (!ALIGN_EPI) { if (wr == 0) PG8_BAR; }
    PG8_BAR;
    if constexpr (Epi::AFTER_DRAIN) { E.fused(acc, cur, wr, wc, fr, fq, lds, wid, lane); S.done(cur); }
#undef PG8_SA
#undef PG8_SB
#undef PG8_STAGE
#undef PG8_LDA
#undef PG8_LDB
#undef PG8_MMA
#undef PG8_WAIT_V
#undef PG8_WAIT_L
#undef PG8_BAR
#undef PG8_SCHED
}
}

namespace cg = cooperative_groups;
#define LAS __attribute__((address_space(3)))
typedef unsigned short bf16;
typedef unsigned v4u __attribute__((ext_vector_type(4)));
typedef unsigned v2u __attribute__((ext_vector_type(2)));
typedef float f32x4 __attribute__((ext_vector_type(4)));
typedef short s16x8 __attribute__((ext_vector_type(8)));
typedef short s16x4 __attribute__((ext_vector_type(4)));

constexpr int NWAVES = 8, NTHR = 512;
constexpr int D = 1024, FF = 2816, NH = 8, HK = 128, HV = 128;
constexpr int PB = 8, PSEQ = 2048, NMETA = 16, PT = PSEQ + NMETA;
constexpr int SB = 128, ST = 8;
constexpr int PROWS = PB * PT;
constexpr int SROW0 = 65 * 256;
constexpr int MROWS = 69 * 256;
static_assert(SROW0 + SB * ST == MROWS && PROWS <= SROW0, "row map");
constexpr int LDS_BYTES = 147456;

constexpr size_t ACT = (size_t)MROWS * D * 2;
constexpr size_t SZ_HIN = (size_t)4096 * 1024 * 2, SZ_SQ = (size_t)1024 * 1024 * 2, SZ_CIN = (size_t)3072 * 1024 * 2, SZ_GU = (size_t)5632 * 1024 * 2, SZ_DN = (size_t)1024 * 2816 * 2;
constexpr size_t WS_W = 0;
constexpr size_t W_HIN0 = WS_W, W_HOUT0 = W_HIN0 + 2 * SZ_HIN, W_CIN0 = W_HOUT0 + 2 * SZ_SQ, W_COUT0 = W_CIN0 + 2 * SZ_CIN, W_GU0 = W_COUT0 + 2 * SZ_SQ, W_DN0 = W_GU0 + 4 * SZ_GU, W_END = W_DN0 + 4 * SZ_DN;
constexpr size_t WS_X = W_END;
constexpr size_t WS_XB = WS_X + (size_t)MROWS * D * 4;
constexpr size_t WS_R = WS_XB + ACT;
constexpr size_t WS_ON = WS_R + 4 * ACT;
constexpr size_t WS_EBL = WS_ON + ACT;
constexpr size_t WS_SS = WS_EBL + (size_t)(MROWS / 8) * D * 4;
constexpr size_t SS1 = (size_t)MROWS * 16 * 4;
constexpr size_t WS_OSS = WS_SS + 9 * SS1;
constexpr size_t OSS1 = (size_t)MROWS * 8 * 4;
constexpr size_t WS_END = WS_OSS + 2 * OSS1;
static_assert((size_t)MROWS * FF * 2 <= 4 * ACT, "H overlays region R");

constexpr size_t O_YP = 0, O_YS = O_YP + (size_t)PB * PSEQ * D, O_HP = O_YS + (size_t)SB * ST * D, O_CP = O_HP + (size_t)2 * PB * NH * HK * HV,
                 O_HS = O_CP + (size_t)2 * PB * 2 * D, O_CS = O_HS + (size_t)2 * SB * NH * HK * HV, O_END = O_CS + (size_t)2 * SB * 2 * D;

struct Args { const float* in[18]; float* out; unsigned char* ws; };

__device__ __forceinline__ float wave_sum(float v) {
#pragma unroll
    for (int o = 1; o < 64; o <<= 1) v += __shfl_xor(v, o);
    return v;
}
__device__ __forceinline__ float bf2f(unsigned short b) { return __uint_as_float((unsigned)b << 16); }
__device__ __forceinline__ unsigned pk2(float lo, float hi) { return pg8::cvt_pk_bf16(lo, hi); }

__device__ __forceinline__ void transpose_item(const float* W, int ldn, int col0, const float* g, bf16* WT, int K, int n0, int k0, LAS float* scr, int lane) {
#pragma unroll 8
    for (int i = 0; i < 32; ++i) { const int kk = 2 * i + (lane >> 5); float v = W[(size_t)(k0 + kk) * ldn + col0 + (lane & 31)]; if (g) v *= g[k0 + kk]; scr[kk * 33 + (lane & 31)] = v; }
    asm volatile("s_waitcnt lgkmcnt(0)" ::: "memory");
    const int c = lane & 7;
#pragma unroll
    for (int j = 0; j < 4; ++j) { const int n = (lane >> 3) + 8 * j; const LAS float* s = scr + (8 * c) * 33 + n;
        v4u o; o.x = pk2(s[0 * 33], s[1 * 33]); o.y = pk2(s[2 * 33], s[3 * 33]); o.z = pk2(s[4 * 33], s[5 * 33]); o.w = pk2(s[6 * 33], s[7 * 33]);
        *(v4u*)(WT + (size_t)(n0 + n) * K + k0 + 8 * c) = o; }
    asm volatile("s_waitcnt lgkmcnt(0)" ::: "memory");
}
constexpr int IT_HIN = 16 * 128, IT_SQ = 16 * 32, IT_CIN = 16 * 96, IT_GU = 16 * 176, IT_DN = 44 * 32;
constexpr int IT_J = IT_HIN + IT_SQ + IT_CIN + IT_SQ, IT_L = IT_GU + IT_DN, IT_TOTAL = 2 * IT_J + 4 * IT_L;

__device__ __forceinline__ void prologue_phase(const Args& a, LAS unsigned char* lds, int gw, int NGW, int lane, int wave) {
    unsigned char* ws = a.ws;
    LAS float* scr = (LAS float*)(lds + wave * 16384);
    for (int it = gw; it < IT_TOTAL; it += NGW) {
        const float* W; const float* g = nullptr; bf16* WT; int ldn, col0, K = 1024, nblk, r;
        if (it < 2 * IT_J) {
            const int j = it / IT_J; r = it % IT_J;
            if (r < IT_HIN) { nblk = 128; const int n0 = (r % nblk) * 32, p = n0 >> 8, rr = n0 & 255;
                W = a.in[8] + (size_t)j * 1024 * 4096; ldn = 4096; g = a.in[5] + (2 * j) * D; WT = (bf16*)(ws + W_HIN0 + j * SZ_HIN);
                col0 = (p < 8) ? ((rr < 128) ? p * 128 + rr : 1024 + p * 128 + (rr - 128)) : n0; }
            else if ((r -= IT_HIN) < IT_SQ) { nblk = 32; W = a.in[9] + (size_t)j * 1024 * 1024; ldn = 1024; WT = (bf16*)(ws + W_HOUT0 + j * SZ_SQ); col0 = (r % nblk) * 32; }
            else if ((r -= IT_SQ) < IT_CIN) { nblk = 96; const int n0 = (r % nblk) * 32, p = n0 >> 8, rr = n0 & 255;
                W = a.in[12] + (size_t)j * 1024 * 3072; ldn = 3072; g = a.in[5] + (2 * j + 1) * D; WT = (bf16*)(ws + W_CIN0 + j * SZ_CIN);
                col0 = (p < 8) ? ((rr < 128) ? 1024 + p * 128 + rr : 2048 + p * 128 + (rr - 128)) : n0 - 2048; }
            else { r -= IT_CIN; nblk = 32; W = a.in[14] + (size_t)j * 1024 * 1024; ldn = 1024; WT = (bf16*)(ws + W_COUT0 + j * SZ_SQ); col0 = (r % nblk) * 32; }
        } else {
            const int q = it - 2 * IT_J, l = q / IT_L; r = q % IT_L;
            if (r < IT_GU) { nblk = 176; const int n0 = (r % nblk) * 32, p = n0 >> 8, rr = n0 & 255;
                W = ((rr < 128) ? a.in[15] : a.in[16]) + (size_t)l * 1024 * 2816; ldn = 2816; g = a.in[6] + l * D; WT = (bf16*)(ws + W_GU0 + l * SZ_GU); col0 = p * 128 + (rr & 127); }
            else { r -= IT_GU; nblk = 32; K = 2816; W = a.in[17] + (size_t)l * 2816 * 1024; ldn = 1024; WT = (bf16*)(ws + W_DN0 + l * SZ_DN); col0 = (r % nblk) * 32; }
        }
        transpose_item(W, ldn, col0, g, WT, K, (r % nblk) * 32, (r / nblk) * 64, scr, lane);
    }
    float* X = (float*)(ws + WS_X); bf16* XB = (bf16*)(ws + WS_XB); float* SS = (float*)(ws + WS_SS);
    for (int row = gw; row < MROWS; row += NGW) {
        const float* src = nullptr;
        if (row < PROWS) { const int b = row / PT, t = row % PT; src = (t < NMETA) ? a.in[4] + (size_t)t * D : a.in[0] + ((size_t)b * PSEQ + (t - NMETA)) * D; }
        else if (row >= SROW0) src = a.in[1] + (size_t)(row - SROW0) * D;
        float s = 0.f;
#pragma unroll
        for (int jj = 0; jj < 4; ++jj) { f32x4 v = src ? *((const f32x4*)src + lane + 64 * jj) : (f32x4){0.f, 0.f, 0.f, 0.f};
            *((f32x4*)(X + (size_t)row * D) + lane + 64 * jj) = v; v2u w; w.x = pk2(v[0], v[1]); w.y = pk2(v[2], v[3]); *((v2u*)(XB + (size_t)row * D) + lane + 64 * jj) = w;
            s += (v[0] * v[0] + v[1] * v[1]) + (v[2] * v[2] + v[3] * v[3]); }
        s = wave_sum(s);
        if (lane < 16) SS[(size_t)row * 16 + lane] = lane == 0 ? s : 0.f;
    }
}

constexpr int SC_ROW = 272, SC_TILE = 16 * SC_ROW, SC_BUF = 4 * SC_TILE + 512, SC_RED = 2 * SC_BUF;
struct ScanT { const bf16 *Qs, *Ks, *V, *Gp; const float* ebl; bf16* ON; float* oss; };
__device__ __forceinline__ void scan_unit(LAS unsigned char* lds, const ScanT& T, int tid, int row0, int nch, int valid, int h, const float* S0, float* Sout, int eidx0) {
    const int lane = tid & 63, w = tid >> 6, fr = lane & 15, fq = lane >> 4;
    const int lt = tid >> 8, lrow = (tid >> 4) & 15, lc = tid & 15;
    const bf16* g0 = (lt == 0 ? T.Qs : T.Ks) + (size_t)(row0 + lrow) * D + h * HK + lc * 8;
    const bf16* g1 = (lt == 0 ? T.V : T.Gp) + (size_t)(row0 + lrow) * D + h * HK + lc * 8;
    const int l0 = lt * SC_TILE + lrow * SC_ROW + lc * 16, l1 = l0 + 2 * SC_TILE;
    const bool lval = lrow < valid;
    f32x4 Sacc[8];
#pragma unroll
    for (int t = 0; t < 8; ++t)
#pragma unroll
        for (int i = 0; i < 4; ++i) Sacc[t][i] = S0 ? S0[(size_t)(16 * t + 4 * fq + i) * HV + 16 * w + fr] : 0.f;
    v4u r0 = (v4u){0u, 0u, 0u, 0u}, r1 = r0; f32x4 re = (f32x4){0.f, 0.f, 0.f, 0.f};
    if (lval) { r0 = *(const v4u*)g0; r1 = *(const v4u*)g1; }
    if (tid < 32) re = *(const f32x4*)(T.ebl + (size_t)eidx0 * D + h * HK + tid * 4);
    *(LAS v4u*)(lds + l0) = r0; *(LAS v4u*)(lds + l1) = r1; if (tid < 32) *(LAS f32x4*)(lds + 4 * SC_TILE + tid * 16) = re;
    __syncthreads();
    for (int c = 0; c < nch; ++c) {
        LAS unsigned char* B = lds + (c & 1) * SC_BUF;
        const bool more = (c + 1 < nch);
        if (more) { const size_t go = (size_t)(c + 1) * 16 * D; if (lval) { r0 = *(const v4u*)(g0 + go); r1 = *(const v4u*)(g1 + go); }
            if (tid < 32) re = *(const f32x4*)(T.ebl + (size_t)(eidx0 + 2 * (c + 1)) * D + h * HK + tid * 4); }
        s16x8 qa[4], ka[4];
#pragma unroll
        for (int s = 0; s < 4; ++s) {
            const LAS unsigned char* pq = B + fr * SC_ROW + 64 * s + 8 * fq; const LAS unsigned char* pk = pq + SC_TILE;
            const s16x4 q0 = *(const LAS s16x4*)pq, q1 = *(const LAS s16x4*)(pq + 32), k0 = *(const LAS s16x4*)pk, k1 = *(const LAS s16x4*)(pk + 32);
            qa[s] = (s16x8){q0[0], q0[1], q0[2], q0[3], q1[0], q1[1], q1[2], q1[3]}; ka[s] = (s16x8){k0[0], k0[1], k0[2], k0[3], k1[0], k1[1], k1[2], k1[3]};
        }
        f32x4 pt = (f32x4){0.f, 0.f, 0.f, 0.f};
#pragma unroll
        for (int s = 0; s < 4; ++s) pt = __builtin_amdgcn_mfma_f32_16x16x32_bf16(ka[s], qa[s], pt, 0, 0, 0);
        float pm[4];
#pragma unroll
        for (int ii = 0; ii < 4; ++ii) pm[ii] = (fr >= 4 * fq + ii) ? pt[ii] : 0.f;
        const unsigned pw0 = pk2(pm[0], pm[1]), pw1 = pk2(pm[2], pm[3]);
        const s16x4 pa = (s16x4){(short)(pw0 & 0xffff), (short)(pw0 >> 16), (short)(pw1 & 0xffff), (short)(pw1 >> 16)};
        const LAS unsigned short* vp = (const LAS unsigned short*)(B + 2 * SC_TILE + (4 * fq) * SC_ROW + (16 * w + fr) * 2);
        const s16x4 vb = (s16x4){(short)vp[0], (short)vp[SC_ROW / 2], (short)vp[SC_ROW], (short)vp[3 * SC_ROW / 2]};
        f32x4 o = __builtin_amdgcn_mfma_f32_16x16x16bf16_1k(pa, vb, (f32x4){0.f, 0.f, 0.f, 0.f}, 0, 0, 0);
#pragma unroll
        for (int s = 0; s < 4; ++s) {
            const unsigned a0 = pk2(Sacc[2 * s][0], Sacc[2 * s][1]), a1 = pk2(Sacc[2 * s][2], Sacc[2 * s][3]), a2 = pk2(Sacc[2 * s + 1][0], Sacc[2 * s + 1][1]), a3 = pk2(Sacc[2 * s + 1][2], Sacc[2 * s + 1][3]);
            const v4u sw = (v4u){a0, a1, a2, a3};
            o = __builtin_amdgcn_mfma_f32_16x16x32_bf16(qa[s], __builtin_bit_cast(s16x8, sw), o, 0, 0, 0);
        }
        const LAS float* ep = (const LAS float*)(B + 4 * SC_TILE);
#pragma unroll
        for (int t = 0; t < 8; ++t) {
            const LAS unsigned short* kp = (const LAS unsigned short*)(B + SC_TILE + (4 * fq) * SC_ROW + (16 * t + fr) * 2);
            const s16x4 kt = (s16x4){(short)kp[0], (short)kp[SC_ROW / 2], (short)kp[SC_ROW], (short)kp[3 * SC_ROW / 2]};
            Sacc[t] = __builtin_amdgcn_mfma_f32_16x16x16bf16_1k(kt, vb, Sacc[t], 0, 0, 0);
            const f32x4 ev = *(const LAS f32x4*)(ep + 16 * t + 4 * fq);
            Sacc[t] = Sacc[t] * ev;
        }
        const LAS unsigned short* gp = (const LAS unsigned short*)(B + 3 * SC_TILE + (4 * fq) * SC_ROW + (16 * w + fr) * 2);
#pragma unroll
        for (int ii = 0; ii < 4; ++ii) {
            const int i = 4 * fq + ii; const float ov = o[ii]; const float gv = bf2f(gp[ii * (SC_ROW / 2)]);
            float q = ov * ov; q += __shfl_xor(q, 1); q += __shfl_xor(q, 2); q += __shfl_xor(q, 4); q += __shfl_xor(q, 8);
            if (i < valid) { const int row = row0 + 16 * c + i;
                T.ON[(size_t)row * D + h * HV + 16 * w + fr] = (bf16)(pk2(ov * gv, 0.f) & 0xffff);
            }
            if (fr == 0) *(LAS float*)(lds + SC_RED + (c & 1) * 512 + w * 64 + i * 4) = q;
        }
        if (more) { LAS unsigned char* N = lds + ((c + 1) & 1) * SC_BUF; *(LAS v4u*)(N + l0) = r0; *(LAS v4u*)(N + l1) = r1; if (tid < 32) *(LAS f32x4*)(N + 4 * SC_TILE + tid * 16) = re; }
        __syncthreads();
        if (tid < valid) { const LAS float* rp = (const LAS float*)(lds + SC_RED + (c & 1) * 512) + tid;
            T.oss[(size_t)(row0 + 16 * c + tid) * 8 + h] = ((rp[0] + rp[16]) + (rp[32] + rp[48])) + ((rp[64] + rp[80]) + (rp[96] + rp[112])); }
    }
#pragma unroll
    for (int t = 0; t < 8; ++t)
#pragma unroll
        for (int i = 0; i < 4; ++i) Sout[(size_t)(16 * t + 4 * fq + i) * HV + 16 * w + fr] = Sacc[t][i];
}
__device__ __forceinline__ void scan_phase(const Args& a, LAS unsigned char* lds, int j, int tid, int G, int blk) {
    unsigned char* ws = a.ws;
    ScanT T; T.Qs = (const bf16*)(ws + WS_R); T.Ks = (const bf16*)(ws + WS_R + ACT); T.V = (const bf16*)(ws + WS_R + 2 * ACT); T.Gp = (const bf16*)(ws + WS_R + 3 * ACT);
    T.ebl = (const float*)(ws + WS_EBL); T.ON = (bf16*)(ws + WS_ON); T.oss = (float*)(ws + WS_OSS + j * OSS1);
    const int NP = PB * NH, NS = SB * NH;
    const bool split = G >= 2 * NP;
    if (!split || blk < NP) {
        for (int u = blk; u < NP; u += (split ? NP : G)) { const int b = u >> 3, h = u & 7;
            scan_unit(lds, T, tid, b * PT, PT / 16, 16, h, nullptr, a.out + O_HP + ((size_t)(j * PB + b) * NH + h) * HK * HV, (b * PT) / 8 + 1); }
    }
    if (!split || blk >= NP) {
        const int s0 = split ? blk - NP : blk, sst = split ? G - NP : G;
        for (int u = s0; u < NS; u += sst) { const int n = u >> 3, h = u & 7;
            scan_unit(lds, T, tid, SROW0 + n * ST, 1, ST, h, a.in[2] + ((size_t)(j * SB + n) * NH + h) * HK * HV, a.out + O_HS + ((size_t)(j * SB + n) * NH + h) * HK * HV, (SROW0 + n * ST) / 8); }
    }
}

__device__ __forceinline__ void conv_phase(const Args& a, int j, int gw, int NGW, int lane) {
    unsigned char* ws = a.ws;
    const bf16* U = (const bf16*)(ws + WS_R); const bf16* GB = (const bf16*)(ws + WS_R + ACT); bf16* CV = (bf16*)(ws + WS_R + 2 * ACT);
    const float* cw = a.in[13] + (size_t)j * 3 * D;
    const int NR = PROWS + SB * ST;
    for (int rr = gw; rr < NR; rr += NGW) {
        int row, t, T; const float* buf = nullptr; float* nout;
        if (rr < PROWS) { row = rr; const int b = rr / PT; t = rr % PT; T = PT; nout = a.out + O_CP + ((size_t)(j * PB + b) * 2) * D; }
        else { const int q = rr - PROWS, n = q >> 3; t = q & 7; T = ST; row = SROW0 + q; buf = a.in[3] + ((size_t)(j * SB + n) * 2) * D; nout = a.out + O_CS + ((size_t)(j * SB + n) * 2) * D; }
#pragma unroll
        for (int hh = 0; hh < 2; ++hh) {
            const int c0 = hh * 512 + lane * 8;
            const v4u u0 = *(const v4u*)(U + (size_t)row * D + c0); const v4u gb = *(const v4u*)(GB + (size_t)row * D + c0);
            float um1[8], um2[8], uc[8], gg[8];
#pragma unroll
            for (int k = 0; k < 4; ++k) { uc[2 * k] = __uint_as_float(u0[k] << 16); uc[2 * k + 1] = __uint_as_float(u0[k] & 0xffff0000u); gg[2 * k] = __uint_as_float(gb[k] << 16); gg[2 * k + 1] = __uint_as_float(gb[k] & 0xffff0000u); }
            if (t >= 1) { const v4u x = *(const v4u*)(U + (size_t)(row - 1) * D + c0);
#pragma unroll
                for (int k = 0; k < 4; ++k) { um1[2 * k] = __uint_as_float(x[k] << 16); um1[2 * k + 1] = __uint_as_float(x[k] & 0xffff0000u); } }
            else {
#pragma unroll
                for (int k = 0; k < 8; ++k) um1[k] = buf ? buf[D + c0 + k] : 0.f; }
            if (t >= 2) { const v4u x = *(const v4u*)(U + (size_t)(row - 2) * D + c0);
#pragma unroll
                for (int k = 0; k < 4; ++k) { um2[2 * k] = __uint_as_float(x[k] << 16); um2[2 * k + 1] = __uint_as_float(x[k] & 0xffff0000u); } }
            else {
#pragma unroll
                for (int k = 0; k < 8; ++k) um2[k] = buf ? buf[(size_t)t * D + c0 + k] : 0.f; }
            float y[8];
#pragma unroll
            for (int k = 0; k < 8; ++k) y[k] = gg[k] * (cw[c0 + k] * um2[k] + cw[D + c0 + k] * um1[k] + cw[2 * D + c0 + k] * uc[k]);
            v4u o; o.x = pk2(y[0], y[1]); o.y = pk2(y[2], y[3]); o.z = pk2(y[4], y[5]); o.w = pk2(y[6], y[7]);
            *(v4u*)(CV + (size_t)row * D + c0) = o;
            if (t >= T - 2) { float* p = nout + (size_t)(t - (T - 2)) * D + c0; *(f32x4*)p = (f32x4){uc[0], uc[1], uc[2], uc[3]}; *(f32x4*)(p + 4) = (f32x4){uc[4], uc[5], uc[6], uc[7]}; }
        }
    }
}

__device__ __forceinline__ void final_phase(const Args& a, int gw, int NGW, int lane) {
    unsigned char* ws = a.ws; const float* X = (const float*)(ws + WS_X); const float* SS = (const float*)(ws + WS_SS + 8 * SS1); const float* g = a.in[7];
    const int NR = PB * PSEQ + SB * ST;
    for (int rr = gw; rr < NR; rr += NGW) {
        int row; float* dst;
        if (rr < PB * PSEQ) { const int b = rr / PSEQ, t = rr % PSEQ; row = b * PT + NMETA + t; dst = a.out + O_YP + (size_t)rr * D; }
        else { const int q = rr - PB * PSEQ; row = SROW0 + q; dst = a.out + O_YS + (size_t)q * D; }
        const float r = pg8::rstd16(SS + (size_t)row * 16);
#pragma unroll
        for (int jj = 0; jj < 4; ++jj) { const f32x4 v = *((const f32x4*)(X + (size_t)row * D) + lane + 64 * jj); const f32x4 gv = *((const f32x4*)g + lane + 64 * jj);
            *((f32x4*)dst + lane + 64 * jj) = v * r * gv; }
    }
}

__global__ void __launch_bounds__(NTHR, 2) trunk_fwd(Args a) {
    extern __shared__ __attribute__((aligned(16))) unsigned char lds_raw[];
    LAS unsigned char* lds = (LAS unsigned char*)lds_raw;
    cg::grid_group grid = cg::this_grid();
    const int G = gridDim.x, blk = blockIdx.x;
    const int vcu = (G % 8 == 0) ? (blk % 8) * (G / 8) + blk / 8 : blk;
    const int NGW = G * NWAVES;
    unsigned char* ws = a.ws;
    float* X = (float*)(ws + WS_X); bf16* XB = (bf16*)(ws + WS_XB);
    bf16* R0 = (bf16*)(ws + WS_R); bf16* R1 = (bf16*)(ws + WS_R + ACT); bf16* R2 = (bf16*)(ws + WS_R + 2 * ACT); bf16* R3 = (bf16*)(ws + WS_R + 3 * ACT);
    bf16* ON = (bf16*)(ws + WS_ON);

#define FRESH_IDS() int tid = threadIdx.x; asm volatile("" : "+v"(tid)); const int lane = tid & 63, wave = __builtin_amdgcn_readfirstlane(tid >> 6); const int gw = vcu * NWAVES + wave; (void)lane; (void)gw
    { FRESH_IDS(); prologue_phase(a, lds, gw, NGW, lane, wave); }
    grid.sync();
    for (int l = 0; l < 4; ++l) {
        const int j = l >> 1;
        float* ss_mix = (float*)(ws + WS_SS + l * SS1); float* ss_ffn = (float*)(ws + WS_SS + (4 + l) * SS1); float* ss_next = (float*)(ws + WS_SS + (l < 3 ? l + 1 : 8) * SS1);
        const bf16* mixA; const bf16* mixW; const float* oss = nullptr;
        if ((l & 1) == 0) {
            { pg8::Gemm g{XB, (const bf16*)(ws + W_HIN0 + j * SZ_HIN), MROWS, 4096, D}; pg8::StaticOrder S; S.init(MROWS, 4096, G, blk);
              pg8::EpiHgrnIn E{ss_mix, a.in[10], j ? a.in[10] + D : nullptr, a.in[11] + j * D, R0, R1, R2, R3, (float*)(ws + WS_EBL)};
              pg8::gemm_phase<pg8::EpiHgrnIn, pg8::StaticOrder, true, true>(lds, g, S, E); }
            grid.sync();
            { FRESH_IDS(); scan_phase(a, lds, j, tid, G, blk); }
            mixA = ON; mixW = (const bf16*)(ws + W_HOUT0 + j * SZ_SQ); oss = (const float*)(ws + WS_OSS + j * OSS1);
        } else {
            { pg8::Gemm g{XB, (const bf16*)(ws + W_CIN0 + j * SZ_CIN), MROWS, 3072, D}; pg8::StaticOrder S; S.init(MROWS, 3072, G, blk);
              pg8::EpiConvIn E{ss_mix, R0, R1};
              pg8::gemm_phase<pg8::EpiConvIn, pg8::StaticOrder, true, true>(lds, g, S, E); }
            grid.sync();
            { FRESH_IDS(); conv_phase(a, j, gw, NGW, lane); }
            mixA = R2; mixW = (const bf16*)(ws + W_COUT0 + j * SZ_SQ);
        }
        grid.sync();
        { pg8::Gemm g{mixA, mixW, MROWS, D, D}; pg8::StaticOrder S; S.init(MROWS, D, G, blk);
          pg8::EpiRes E{X, XB, oss, ss_ffn};
          pg8::gemm_phase<pg8::EpiRes, pg8::StaticOrder, true, true>(lds, g, S, E); }
        grid.sync();
        { pg8::Gemm g{XB, (const bf16*)(ws + W_GU0 + l * SZ_GU), MROWS, 5632, D}; pg8::StaticOrder S; S.init(MROWS, 5632, G, blk);
          pg8::EpiGU E{ss_ffn, R0};
          pg8::gemm_phase<pg8::EpiGU, pg8::StaticOrder, true, true>(lds, g, S, E); }
        grid.sync();
        { pg8::Gemm g{R0, (const bf16*)(ws + W_DN0 + l * SZ_DN), MROWS, D, FF}; pg8::StaticOrder S; S.init(MROWS, D, G, blk);
          pg8::EpiRes E{X, XB, nullptr, ss_next};
          pg8::gemm_phase<pg8::EpiRes, pg8::StaticOrder, true, true>(lds, g, S, E); }
        grid.sync();
    }
    { FRESH_IDS(); final_phase(a, gw, NGW, lane); }
}

extern "C" void kernel_launch(void* const* d_in, const int* in_sizes, int n_in, void* d_out, int out_size, void* d_ws, size_t ws_size, hipStream_t stream) {
    static int grid = 0;
    if (grid == 0) {
        if (n_in != 18 || (size_t)out_size != O_END || ws_size < WS_END) { fprintf(stderr, "kernel_launch: unexpected shapes (n_in %d out %d ws %zu need %zu)\n", n_in, out_size, ws_size, (size_t)WS_END); grid = -1; return; }
        int dev = 0, cus = 0, per_cu = 0;
        hipGetDevice(&dev); hipDeviceGetAttribute(&cus, hipDeviceAttributeMultiprocessorCount, dev);
        hipFuncSetAttribute((const void*)trunk_fwd, hipFuncAttributeMaxDynamicSharedMemorySize, LDS_BYTES);
        hipOccupancyMaxActiveBlocksPerMultiprocessor(&per_cu, (const void*)trunk_fwd, NTHR, LDS_BYTES);
        if (per_cu < 1) { fprintf(stderr, "kernel_launch: occupancy query says %d blocks per CU\n", per_cu); per_cu = 1; }
        if (per_cu > 1) per_cu = 1;
        grid = cus * per_cu;
    }
    if (grid < 0) return;
    Args a{};
    for (int i = 0; i < 18; ++i) a.in[i] = (const float*)d_in[i];
    a.out = (float*)d_out; a.ws = (unsigned char*)d_ws;
    void* args[] = {&a};
    hipError_t e = hipLaunchCooperativeKernel((const void*)trunk_fwd, dim3(grid), dim3(NTHR), args, LDS_BYTES, stream);
    if (e != hipSuccess) fprintf(stderr, "cooperative launch failed: %s (grid %d)\n", hipGetErrorString(e), grid);
}
```
